# Optimizing an MI355X kernel written in HIP

```python
import math
import jax, jax.numpy as jnp
from jax import lax
import numpy as np

D_MODEL = 1024
BATCH = 8
SEQ = 4096
DEPTH = 1

HEAD_DIM = 64
A_Q_HEADS = 8
A_KV_HEADS = 2
A_GROUP = A_Q_HEADS // A_KV_HEADS
A_HALF_WINDOW = 128
A_BLOCK = 128
B_PATTERNS = ((128, 1), (512, 4), (2048, 16))
B_N_GROUPS = len(B_PATTERNS)
B_HEADS_PER_GROUP = 4
B_BLOCK = 64
ROPE_THETA = 10000.0
D_FF = 3 * D_MODEL
CONV_WIDTH = 3
RMS_EPS = 1e-6
NEG_INF = -1e30

A_Q_COLS = A_Q_HEADS * HEAD_DIM
A_KV_COLS = A_KV_HEADS * HEAD_DIM
A_COLS = A_Q_COLS + 2 * A_KV_COLS
B_PROJ_COLS = B_N_GROUPS * B_HEADS_PER_GROUP * HEAD_DIM
IN_COLS = A_COLS + 3 * B_PROJ_COLS
A_OUT = A_Q_COLS
B_OUT = B_HEADS_PER_GROUP * HEAD_DIM

kernel_name = "hybrid_gated_window_dilated_attention_convffn"


def rms_norm(x, gain):
    xf = x.astype(jnp.float32)
    y = xf * lax.rsqrt(jnp.mean(xf * xf, axis=-1, keepdims=True) + RMS_EPS)
    return (y * gain.astype(jnp.float32)).astype(x.dtype)


def rope(t, seq_len):
    dh = t.shape[-1]
    half = dh // 2
    inv = ROPE_THETA ** (-jnp.arange(half, dtype=jnp.float32) / half)
    ang = jnp.arange(seq_len, dtype=jnp.float32)[:, None] * inv[None, :]
    bshape = (1, seq_len) + (1,) * (t.ndim - 3) + (half,)
    cos = jnp.cos(ang).reshape(bshape)
    sin = jnp.sin(ang).reshape(bshape)
    tf = t.astype(jnp.float32)
    t1, t2 = tf[..., :half], tf[..., half:]
    return jnp.concatenate([t1 * cos - t2 * sin, t2 * cos + t1 * sin], axis=-1).astype(t.dtype)


def banded_attention(q, k, v, half_window, block, sink=None):
    b, L, hkv, g, dh = q.shape
    nb = -(-L // block)
    lp = nb * block
    qp = jnp.pad(q, ((0, 0), (0, lp - L), (0, 0), (0, 0), (0, 0))).reshape(b, nb, block, hkv, g, dh)

    def key_windows(t):
        tp = jnp.pad(t, ((0, 0), (block, lp - L + block), (0, 0), (0, 0))).reshape(b, nb + 2, block, hkv, dh)
        return jnp.concatenate([tp[:, :-2], tp[:, 1:-1], tp[:, 2:]], axis=2)

    kw = key_windows(k)
    vw = key_windows(v)
    qi = jnp.arange(nb)[:, None] * block + jnp.arange(block)[None, :]
    kj = (jnp.arange(nb)[:, None] - 1) * block + jnp.arange(3 * block)[None, :]
    kjb = kj[:, None, :]
    mask = (jnp.abs(kjb - qi[:, :, None]) <= half_window) & (kjb >= 0) & (kjb < L)

    s = jnp.einsum('bnqhgd,bnkhd->bnhgqk', qp.astype(jnp.float32), kw.astype(jnp.float32)) * (dh ** -0.5)
    s = jnp.where(mask[None, :, None, None], s, NEG_INF)
    m = jnp.max(s, axis=-1)
    if sink is not None:
        sk = sink.astype(jnp.float32)[None, None, :, :, None]
        m = jnp.maximum(m, sk)
    p = jnp.exp(s - m[..., None])
    denom = jnp.sum(p, axis=-1)
    if sink is not None:
        denom = denom + jnp.exp(sk - m)
    o = jnp.einsum('bnhgqk,bnkhd->bnqhgd', p, vw.astype(jnp.float32))
    o = o / jnp.moveaxis(denom, -1, 2)[..., None]
    o = o.reshape(b, lp, hkv, g, dh)[:, :L].astype(q.dtype)
    lse = jnp.moveaxis(m + jnp.log(denom), -1, 2).reshape(b, lp, hkv, g)[:, :L]
    return o, lse


def stride_gather(t, d):
    b, s = t.shape[0], t.shape[1]
    t = t.reshape((b, s // d, d) + t.shape[2:])
    t = jnp.moveaxis(t, 2, 1)
    return t.reshape((b * d, s // d) + t.shape[3:])


def stride_scatter(t, d, b):
    sd = t.shape[1]
    t = t.reshape((b, d, sd) + t.shape[2:])
    t = jnp.moveaxis(t, 1, 2)
    return t.reshape((b, sd * d) + t.shape[3:])


def depthwise_conv_centered(u, w, bias):
    up = jnp.pad(u, ((0, 0), (1, 1), (0, 0)))
    return up[:, :-2] * w[0] + up[:, 1:-1] * w[1] + up[:, 2:] * w[2] + bias


def token_mixer(h, w_in, sink, w_branch_a, w_branch_b, w_gate, b_gate, w_out):
    b, s, _ = h.shape
    proj = h @ w_in
    qa = proj[..., :A_Q_COLS].reshape(b, s, A_KV_HEADS, A_GROUP, HEAD_DIM)
    ka = proj[..., A_Q_COLS:A_Q_COLS + A_KV_COLS].reshape(b, s, A_KV_HEADS, HEAD_DIM)
    va = proj[..., A_Q_COLS + A_KV_COLS:A_COLS].reshape(b, s, A_KV_HEADS, HEAD_DIM)
    qa = rope(qa, s)
    ka = rope(ka, s)
    ya, _ = banded_attention(qa, ka, va, A_HALF_WINDOW, A_BLOCK,
                             sink=sink.reshape(A_KV_HEADS, A_GROUP))
    ya = ya.reshape(b, s, A_OUT)
    off = A_COLS
    qb = proj[..., off:off + B_PROJ_COLS].reshape(b, s, B_N_GROUPS, B_HEADS_PER_GROUP, HEAD_DIM)
    kb = proj[..., off + B_PROJ_COLS:off + 2 * B_PROJ_COLS].reshape(b, s, B_N_GROUPS, B_HEADS_PER_GROUP, HEAD_DIM)
    vb = proj[..., off + 2 * B_PROJ_COLS:off + 3 * B_PROJ_COLS].reshape(b, s, B_N_GROUPS, B_HEADS_PER_GROUP, HEAD_DIM)
    qb = rope(qb, s)
    kb = rope(kb, s)
    outs, lses = [], []
    for gi, (window, dil) in enumerate(B_PATTERNS):
        qg = stride_gather(qb[:, :, gi], dil)[:, :, :, None, :]
        kg = stride_gather(kb[:, :, gi], dil)
        vg = stride_gather(vb[:, :, gi], dil)
        og, lg = banded_attention(qg, kg, vg, window // (2 * dil), B_BLOCK)
        outs.append(stride_scatter(og[:, :, :, 0], dil, b))
        lses.append(stride_scatter(lg[:, :, :, 0], dil, b))
    outs = jnp.stack(outs, axis=2)
    wts = jax.nn.softmax(jnp.stack(lses, axis=2), axis=2)
    yb = jnp.sum(wts[..., None] * outs.astype(jnp.float32), axis=2).astype(h.dtype).reshape(b, s, B_OUT)
    gates = jax.nn.sigmoid((h @ w_gate + b_gate).astype(jnp.float32)).astype(h.dtype)
    ga, gb = gates[..., :D_MODEL], gates[..., D_MODEL:]
    merged = ga * (ya @ w_branch_a) + gb * (yb @ w_branch_b)
    return merged @ w_out


def conv_ffn(h, w_up, conv_w, conv_b, w_down):
    u = depthwise_conv_centered(h @ w_up, conv_w, conv_b)
    gate, up = u[..., :D_FF], u[..., D_FF:]
    return (jax.nn.gelu(gate, approximate=True) * up) @ w_down


def setup_inputs(seed: int = 0) -> dict:
    key = jax.random.key(seed)
    ks = jax.random.split(key, 20)
    f32 = jnp.float32

    def nrm(k, shape, scale):
        return jax.random.normal(k, shape, f32) * scale

    def gain(k):
        return 1.0 + 0.05 * jax.random.normal(k, (DEPTH, D_MODEL), f32)

    return {
        "x": jax.random.normal(ks[0], (BATCH, SEQ, D_MODEL), f32),
        "norm_mix_pre": gain(ks[1]),
        "w_in": nrm(ks[2], (DEPTH, D_MODEL, IN_COLS), D_MODEL ** -0.5),
        "sink": nrm(ks[3], (DEPTH, A_Q_HEADS), 1.0),
        "w_branch_a": nrm(ks[4], (DEPTH, A_OUT, D_MODEL), A_OUT ** -0.5),
        "w_branch_b": nrm(ks[5], (DEPTH, B_OUT, D_MODEL), B_OUT ** -0.5),
        "w_gate": nrm(ks[6], (DEPTH, D_MODEL, 2 * D_MODEL), D_MODEL ** -0.5),
        "b_gate": nrm(ks[7], (DEPTH, 2 * D_MODEL), 0.02),
        "w_out": nrm(ks[8], (DEPTH, D_MODEL, D_MODEL), D_MODEL ** -0.5),
        "norm_mix_post": gain(ks[9]),
        "norm_ffn_pre": gain(ks[10]),
        "w_up": nrm(ks[11], (DEPTH, D_MODEL, 2 * D_FF), D_MODEL ** -0.5),
        "conv_w": nrm(ks[12], (DEPTH, CONV_WIDTH, 2 * D_FF), CONV_WIDTH ** -0.5),
        "conv_b": nrm(ks[13], (DEPTH, 2 * D_FF), 0.02),
        "w_down": nrm(ks[14], (DEPTH, D_FF, D_MODEL), D_FF ** -0.5),
        "norm_ffn_post": gain(ks[15]),
    }


def reference(x, norm_mix_pre, w_in, sink, w_branch_a, w_branch_b, w_gate, b_gate, w_out,
              norm_mix_post, norm_ffn_pre, w_up, conv_w, conv_b, w_down, norm_ffn_post):
    for layer in range(DEPTH):
        h = rms_norm(x, norm_mix_pre[layer])
        mix = token_mixer(h, w_in[layer], sink[layer], w_branch_a[layer], w_branch_b[layer],
                          w_gate[layer], b_gate[layer], w_out[layer])
        x = x + rms_norm(mix, norm_mix_post[layer])
        h = rms_norm(x, norm_ffn_pre[layer])
        f = conv_ffn(h, w_up[layer], conv_w[layer], conv_b[layer], w_down[layer])
        x = x + rms_norm(f, norm_ffn_post[layer])
    return x
```

```cpp
#include <hip/hip_runtime.h>
#include <hip/hip_cooperative_groups.h>
#include <cstdio>
#include <cstdint>
namespace cg = cooperative_groups;

#define LAS __attribute__((address_space(3)))
#define DI __device__ __forceinline__
typedef unsigned short bf16_t;
typedef short bf16x8 __attribute__((ext_vector_type(8)));
typedef short s16x4 __attribute__((ext_vector_type(4)));
typedef float f32x4 __attribute__((ext_vector_type(4)));
typedef float f32x16 __attribute__((ext_vector_type(16)));
typedef unsigned u32x4 __attribute__((ext_vector_type(4)));
typedef unsigned u32x2 __attribute__((ext_vector_type(2)));
typedef __bf16 bf16x2_t __attribute__((ext_vector_type(2)));
typedef float f32x2_t __attribute__((ext_vector_type(2)));

DI unsigned pk2(float lo, float hi) { f32x2_t v = {lo, hi}; bf16x2_t b = __builtin_convertvector(v, bf16x2_t); return __builtin_bit_cast(unsigned, b); }
DI float bf_lo(unsigned w) { return __uint_as_float(w << 16); }
DI float bf_hi(unsigned w) { return __uint_as_float(w & 0xffff0000u); }

constexpr int SEQ = 4096, NB = 8, M = NB * SEQ, D = 1024, FF = 3072;
constexpr int N1 = 5120;
constexpr int PROJ_LD = 3072, GATE_LD = 2048;
constexpr int H2_ROWS = 4320;
constexpr int CONV_TILES = 17;
constexpr float RMS_EPS = 1e-6f;
constexpr float LOG2E = 1.4426950408889634f;

constexpr size_t MiB = 1u << 20;
constexpr size_t WS_ROWSQ1 = 0, WS_ROWSQ2 = 128 * 1024;
constexpr size_t WS_BAR = 512 * 1024;
constexpr size_t WS_ROPE = 1 * MiB;
constexpr size_t WS_W1T = 2 * MiB, WS_WAT = 12 * MiB, WS_WBT = 13 * MiB, WS_WOT = 14 * MiB, WS_WUPT = 16 * MiB, WS_WDT = 28 * MiB;
constexpr size_t WS_H = 36 * MiB;
constexpr size_t WS_PROJ = 100 * MiB;
constexpr size_t WS_YB = WS_PROJ, WS_TMP = WS_PROJ + 16 * MiB, WS_H2P = WS_PROJ, WS_F = WS_PROJ;
constexpr size_t WS_GATES = 292 * MiB;
constexpr size_t WS_O = WS_GATES, WS_ACT = WS_GATES;
constexpr size_t WS_YA = 420 * MiB, WS_OBG = 452 * MiB, WS_LSE = 500 * MiB;
constexpr size_t WS_END_REQ = 512 * MiB;

constexpr int RING_BYTES = 131072, EDGE_OFF = RING_BYTES, EDGE_BYTES = 8192, LDS_BYTES = 147456;

namespace pg8 {
constexpr int BM = 256, BK = 64, HALF = 128, HTB = HALF * BK * 2, STAGE_BYTES = 8 * HTB, NXCD = 8, WGM = 8;
__host__ __device__ __forceinline__ int lds_byte(int r, int c) { const int st = (r >> 4) * 2 + (c >> 5), rr = r & 15, cc = c & 31, ob = rr * 64 + cc * 2; return st * 1024 + (ob ^ (((ob >> 9) & 1) << 5)); }
__host__ __device__ __forceinline__ void stage_rc(int b, int& R, int& C) { const int st = b / 1024, sb = b % 1024, swz = sb ^ (((sb >> 9) & 1) << 5); R = (st >> 1) * 16 + swz / 64; C = (st & 1) * 32 + (swz % 64) / 2; }
__host__ __device__ __forceinline__ int perm32(int rho) { const int n = rho >> 4, i = rho & 15; return 8 * (i >> 2) + 4 * n + (i & 3); }

struct Unit { int pm, pn; };
struct Gemm { const bf16_t* A; const bf16_t* Bt; int K; };

struct StaticOrder {
    int nM, nN, nwg, G, c, conv;
    __device__ void init(int nM_, int nN_, int G_, int c_, int conv_) { nM = nM_; nN = nN_; nwg = nM * nN; G = G_; c = c_; conv = conv_; }
    __device__ bool next(int i, Unit& u) const {
        const long L = (long)i * G + c; if (L >= nwg) return false;
        int wgid = (int)L; { const int q = nwg / NXCD, r = nwg % NXCD, xcd = wgid % NXCD, off = wgid / NXCD; wgid = (xcd < r ? xcd * (q + 1) : r * (q + 1) + (xcd - r) * q) + off; }
        const int nig = WGM * nN, gid = wgid / nig, fm = gid * WGM, gsz = (nM - fm) < WGM ? (nM - fm) : WGM;
        u.pm = fm + ((wgid % nig) % gsz); u.pn = (wgid % nig) / gsz; return true;
    }
    __device__ __forceinline__ int arow(const Unit& u) const { return conv ? (u.pm / CONV_TILES) * H2_ROWS + (u.pm % CONV_TILES) * 254 : u.pm * BM; }
};

template <class Epi, class Sched>
__device__ __forceinline__ void gemm_phase(LAS unsigned char* lds, const Gemm g, const Sched& S, const Epi& E) {
    const int tid = threadIdx.x, wid = __builtin_amdgcn_readfirstlane(tid >> 6), lane = tid & 63, wr = wid >> 2, wc = wid & 3, fr = lane & 15, fq = lane >> 4;
    const int K = g.K, nt = K / BK;
    unsigned voffA[2], voffB[2];
#pragma unroll
    for (int i = 0; i < 2; ++i) { int R, C; stage_rc(tid * 16 + i * 8192, R, C); const int Rb = (R & ~31) + perm32(R & 31);
        voffA[i] = (unsigned)(R * K + C) * 2u; voffB[i] = (unsigned)(Rb * K + C) * 2u; }
    const size_t kstep = (size_t)(BK * 2);
    const size_t rowb = (size_t)K * 2;
    const size_t hstep = (size_t)HALF * K * 2;
    const size_t tstep = 2 * hstep;
    const unsigned ldsw = (unsigned)wid * 1024u;
    const int aoff = lds_byte(wr * 64 + fr, fq * 8), boff = lds_byte(wc * 32 + fr, fq * 8);
#define PG8_SA(b, h) (((b) * 2 + (h)) * HTB)
#define PG8_SB(b, h) ((4 + (b) * 2 + (h)) * HTB)
#define PG8_STAGE(bufoff, gbase, voff) do { _Pragma("unroll") for (int _i = 0; _i < 2; ++_i) \
        __builtin_amdgcn_global_load_lds((const unsigned*)((const char*)(gbase) + (voff)[_i]), (LAS unsigned*)(lds + (bufoff) + ldsw + _i * 8192), 16, 0, 0); } while (0)
#define PG8_LDA(dst, b, h) do { _Pragma("unroll") for (int m = 0; m < 4; ++m) _Pragma("unroll") for (int k = 0; k < 2; ++k) dst[m][k] = *(const LAS bf16x8*)(lds + PG8_SA(b, h) + aoff + m * 2048 + k * 1024); } while (0)
#define PG8_LDB(dst, b, h) do { _Pragma("unroll") for (int n = 0; n < 2; ++n) _Pragma("unroll") for (int k = 0; k < 2; ++k) dst[n][k] = *(const LAS bf16x8*)(lds + PG8_SB(b, h) + boff + n * 2048 + k * 1024); } while (0)
#define PG8_MMA(ai, bj, At, Bt) do { __builtin_amdgcn_s_setprio(1); _Pragma("unroll") for (int m = 0; m < 4; ++m) _Pragma("unroll") for (int n = 0; n < 2; ++n) _Pragma("unroll") for (int k = 0; k < 2; ++k) \
        acc[ai][bj][m][n] = __builtin_amdgcn_mfma_f32_16x16x32_bf16(Bt[n][k], At[m][k], acc[ai][bj][m][n], 0, 0, 0); __builtin_amdgcn_s_setprio(0); } while (0)
#define PG8_WAIT_V(n) asm volatile("s_waitcnt vmcnt(" #n ")" ::: "memory")
#define PG8_WAIT_L(n) asm volatile("s_waitcnt lgkmcnt(" #n ")" ::: "memory")
#define PG8_BAR __builtin_amdgcn_s_barrier()
#define PG8_SCHED __builtin_amdgcn_sched_barrier(0)
    Unit cur, nxt; int ui = 0;
    if (!S.next(0, cur)) return;
    f32x4 acc[2][2][4][2];
#pragma unroll
    for (int a = 0; a < 2; ++a)
#pragma unroll
        for (int b = 0; b < 2; ++b)
#pragma unroll
            for (int m = 0; m < 4; ++m)
#pragma unroll
                for (int n = 0; n < 2; ++n) acc[a][b][m][n] = (f32x4){0.f, 0.f, 0.f, 0.f};
    bf16x8 At[4][2], B0[2][2], B1[2][2];
    const char* cA = (const char*)g.A + (size_t)S.arow(cur) * rowb; const char* cB = (const char*)g.Bt + (size_t)cur.pn * tstep;
    PG8_STAGE(PG8_SB(0, 0), cB, voffB); PG8_STAGE(PG8_SB(0, 1), cB + hstep, voffB); PG8_STAGE(PG8_SA(0, 0), cA, voffA); PG8_STAGE(PG8_SA(0, 1), cA + hstep, voffA);
    if (wr == 1) PG8_BAR;
    PG8_WAIT_V(2); PG8_BAR;
    PG8_STAGE(PG8_SB(1, 0), cB + kstep, voffB); PG8_STAGE(PG8_SA(1, 0), cA + kstep, voffA); PG8_STAGE(PG8_SB(1, 1), cB + hstep + kstep, voffB);
    PG8_WAIT_V(6); PG8_BAR;
    for (;;) {
        const bool has_next = S.next(ui + 1, nxt);
        const char* nA = has_next ? (const char*)g.A + (size_t)S.arow(nxt) * rowb : cA; const char* nB = has_next ? (const char*)g.Bt + (size_t)nxt.pn * tstep : cB;
        for (int t = 0; t < nt; t += 2) {
            const bool last = (t == nt - 2);
            const char* a1 = cA + (size_t)(t + 1) * kstep;
            const char* a2 = last ? nA : cA + (size_t)(t + 2) * kstep; const char* b2 = last ? nB : cB + (size_t)(t + 2) * kstep;
            const char* a3 = a2 + kstep; const char* b3 = b2 + kstep;
            PG8_LDB(B0, 0, 0); PG8_LDB(B1, 0, 1); PG8_SCHED; PG8_LDA(At, 0, 0); PG8_STAGE(PG8_SA(1, 1), a1 + hstep, voffA);
            PG8_WAIT_V(8); PG8_WAIT_L(0); PG8_BAR; PG8_MMA(0, 0, At, B0); PG8_MMA(0, 1, At, B1); PG8_BAR; PG8_SCHED;
            PG8_LDA(At, 0, 1); PG8_STAGE(PG8_SB(0, 0), b2, voffB); PG8_STAGE(PG8_SB(0, 1), b2 + hstep, voffB); PG8_STAGE(PG8_SA(0, 0), a2, voffA);
            PG8_WAIT_V(8); PG8_WAIT_L(0); PG8_BAR; PG8_MMA(1, 0, At, B0); PG8_MMA(1, 1, At, B1); PG8_BAR; PG8_SCHED;
            PG8_LDB(B0, 1, 0); PG8_LDB(B1, 1, 1); PG8_SCHED; PG8_LDA(At, 1, 0); PG8_STAGE(PG8_SA(0, 1), a2 + hstep, voffA);
            PG8_WAIT_V(8); PG8_WAIT_L(0); PG8_BAR; PG8_MMA(0, 0, At, B0); PG8_MMA(0, 1, At, B1); PG8_BAR; PG8_SCHED;
            PG8_LDA(At, 1, 1); PG8_STAGE(PG8_SB(1, 0), b3, voffB); PG8_STAGE(PG8_SB(1, 1), b3 + hstep, voffB); PG8_STAGE(PG8_SA(1, 0), a3, voffA);
            PG8_WAIT_V(8); PG8_WAIT_L(0); PG8_BAR; PG8_MMA(1, 0, At, B0); PG8_MMA(1, 1, At, B1); PG8_BAR; PG8_SCHED;
        }
        if (wr == 0) PG8_BAR;
        { int lane2; asm volatile("v_mbcnt_lo_u32_b32 %0, -1, 0\n\tv_mbcnt_hi_u32_b32 %0, -1, %0" : "=v"(lane2));
          E(acc, cur, wr, wc, lane2 & 15, lane2 >> 4); }
        if (!has_next) break;
#pragma unroll
        for (int a = 0; a < 2; ++a)
#pragma unroll
            for (int b = 0; b < 2; ++b)
#pragma unroll
                for (int m = 0; m < 4; ++m)
#pragma unroll
                    for (int n = 0; n < 2; ++n) acc[a][b][m][n] = (f32x4){0.f, 0.f, 0.f, 0.f};
        cur = nxt; cA = nA; cB = nB; ++ui;
        if (wr == 1) PG8_BAR;
    }
    PG8_WAIT_V(0);
    PG8_BAR;
#undef PG8_SA
#undef PG8_SB
#undef PG8_STAGE
#undef PG8_LDA
#undef PG8_LDB
#undef PG8_MMA
#undef PG8_WAIT_V
#undef PG8_WAIT_L
#undef PG8_BAR
#undef PG8_SCHED
}

typedef f32x4 Acc[2][2][4][2];

DI u32x4 pack8(f32x4 v0, f32x4 v1) { u32x4 w; w.x = pk2(v0[0], v0[1]); w.y = pk2(v0[2], v0[3]); w.z = pk2(v1[0], v1[1]); w.w = pk2(v1[2], v1[3]); return w; }
DI void unpack8(u32x4 w, f32x4& v0, f32x4& v1) { v0 = (f32x4){bf_lo(w.x), bf_hi(w.x), bf_lo(w.y), bf_hi(w.y)}; v1 = (f32x4){bf_lo(w.z), bf_hi(w.z), bf_lo(w.w), bf_hi(w.w)}; }
DI float sigmoidf_(float x) { return __builtin_amdgcn_rcpf(1.f + __builtin_amdgcn_exp2f(-x * LOG2E)); }

struct EpiProj {
    bf16_t* proj; bf16_t* gates; const float* bgate; const float* rcos; const float* rsin;
    __device__ __forceinline__ void operator()(const Acc& acc, const Unit& u, int wr, int wc, int fr, int fq) const {
        const int row0 = u.pm * BM + wr * 64 + fr;
#pragma unroll
        for (int bj = 0; bj < 2; ++bj) {
            const int c128 = 2 * u.pn + bj;
            if (c128 >= 24) {
                const int gcol = (c128 - 24) * 128 + wc * 32 + 8 * fq;
                const f32x4 b0 = *(const f32x4*)(bgate + gcol), b1 = *(const f32x4*)(bgate + gcol + 4);
#pragma unroll
                for (int ai = 0; ai < 2; ++ai)
#pragma unroll
                    for (int m = 0; m < 4; ++m) {
                        const int row = row0 + ai * HALF + m * 16;
                        f32x4 v0 = acc[ai][bj][m][0] + b0, v1 = acc[ai][bj][m][1] + b1;
#pragma unroll
                        for (int j = 0; j < 4; ++j) { v0[j] = sigmoidf_(v0[j]); v1[j] = sigmoidf_(v1[j]); }
                        *(u32x4*)(gates + (size_t)row * GATE_LD + gcol) = pack8(v0, v1);
                    }
            } else if (c128 == 5 || c128 >= 18) {
                const int col = c128 * 128 + wc * 32 + 8 * fq;
#pragma unroll
                for (int ai = 0; ai < 2; ++ai)
#pragma unroll
                    for (int m = 0; m < 4; ++m) {
                        const int row = row0 + ai * HALF + m * 16;
                        *(u32x4*)(proj + (size_t)row * PROJ_LD + col) = pack8(acc[ai][bj][m][0], acc[ai][bj][m][1]);
                    }
            } else {
                const int headbase = c128 * 128 + (wc >> 1) * 64, d0 = 16 * (wc & 1) + 4 * fq;
                const float sc = (c128 < 4 || (c128 >= 6 && c128 < 12)) ? 0.125f : 1.0f;
#pragma unroll
                for (int ai = 0; ai < 2; ++ai)
#pragma unroll
                    for (int m = 0; m < 4; ++m) {
                        const int row = row0 + ai * HALF + m * 16, s = row & (SEQ - 1);
                        const f32x4 cs = *(const f32x4*)(rcos + s * 32 + d0) * sc, sn = *(const f32x4*)(rsin + s * 32 + d0) * sc;
                        const f32x4 t1 = acc[ai][bj][m][0], t2 = acc[ai][bj][m][1];
                        const f32x4 o1 = t1 * cs - t2 * sn, o2 = t2 * cs + t1 * sn;
                        bf16_t* p = proj + (size_t)row * PROJ_LD + headbase + d0;
                        u32x2 w1, w2; w1.x = pk2(o1[0], o1[1]); w1.y = pk2(o1[2], o1[3]); w2.x = pk2(o2[0], o2[1]); w2.y = pk2(o2[2], o2[3]);
                        *(u32x2*)p = w1; *(u32x2*)(p + 32) = w2;
                    }
            }
        }
    }
};

template <int SECOND> struct EpiGate {
    const bf16_t* gates; float* tmp; bf16_t* merged;
    __device__ __forceinline__ void operator()(const Acc& acc, const Unit& u, int wr, int wc, int fr, int fq) const {
        const int row0 = u.pm * BM + wr * 64 + fr, col0 = u.pn * BM + wc * 32 + 8 * fq;
#pragma unroll
        for (int ai = 0; ai < 2; ++ai)
#pragma unroll
            for (int m = 0; m < 4; ++m) {
                const int row = row0 + ai * HALF + m * 16;
#pragma unroll
                for (int bj = 0; bj < 2; ++bj) {
                    const int col = col0 + bj * HALF;
                    f32x4 g0, g1; unpack8(*(const u32x4*)(gates + (size_t)row * GATE_LD + SECOND * 1024 + col), g0, g1);
                    float* tp = tmp + (size_t)row * D + col;
                    if (SECOND == 0) { *(f32x4*)tp = g0 * acc[ai][bj][m][0]; *(f32x4*)(tp + 4) = g1 * acc[ai][bj][m][1]; }
                    else { const f32x4 v0 = *(const f32x4*)tp + g0 * acc[ai][bj][m][0], v1 = *(const f32x4*)(tp + 4) + g1 * acc[ai][bj][m][1];
                           *(u32x4*)(merged + (size_t)row * D + col) = pack8(v0, v1); }
                }
            }
    }
};

struct EpiOutSq {
    float* out; float* rowsq;
    __device__ __forceinline__ void operator()(const Acc& acc, const Unit& u, int wr, int wc, int fr, int fq) const {
        const int row0 = u.pm * BM + wr * 64 + fr, col0 = u.pn * BM + wc * 32 + 8 * fq;
#pragma unroll
        for (int ai = 0; ai < 2; ++ai)
#pragma unroll
            for (int m = 0; m < 4; ++m) {
                const int row = row0 + ai * HALF + m * 16; float s = 0.f;
#pragma unroll
                for (int bj = 0; bj < 2; ++bj) {
                    const f32x4 v0 = acc[ai][bj][m][0], v1 = acc[ai][bj][m][1];
                    float* op = out + (size_t)row * D + col0 + bj * HALF;
                    *(f32x4*)op = v0; *(f32x4*)(op + 4) = v1;
                    s += (v0[0] * v0[0] + v0[1] * v0[1]) + (v0[2] * v0[2] + v0[3] * v0[3]) + (v1[0] * v1[0] + v1[1] * v1[1]) + (v1[2] * v1[2] + v1[3] * v1[3]);
                }
                s += __shfl_xor(s, 16); s += __shfl_xor(s, 32);
                if (fq == 0) atomicAdd(rowsq + row, s);
            }
    }
};

DI float gelu_tanh(float x) { const float z = 1.5957691216057308f * (x + 0.044715f * x * x * x); return x * __builtin_amdgcn_rcpf(1.f + __builtin_amdgcn_exp2f(-z * LOG2E)); }
struct EpiConv {
    bf16_t* act; const float* cw; const float* cb; LAS float* edge;
    __device__ __forceinline__ void operator()(const Acc& acc, const Unit& u, int wr, int wc, int fr, int fq) const {
        const int lane = fq * 16 + fr;
        const int b = u.pm / CONV_TILES, t = u.pm % CONV_TILES;
        const int c0 = wc * 32 + 8 * fq;
#pragma unroll
        for (int ai = 0; ai < 2; ++ai) {
            const int k = 2 * ai + wr;
#pragma unroll
            for (int bj = 0; bj < 2; ++bj)
#pragma unroll
                for (int n = 0; n < 2; ++n) {
                    if (fr == 0) *(LAS f32x4*)(edge + (k * 2 + 0) * 256 + bj * 128 + c0 + 4 * n) = acc[ai][bj][0][n];
                    if (fr == 15) *(LAS f32x4*)(edge + (k * 2 + 1) * 256 + bj * 128 + c0 + 4 * n) = acc[ai][bj][3][n];
                }
        }
        LAS float* wl = edge + 2048;
        { const int tid2 = (wr * 4 + wc) * 64 + lane;
#pragma unroll
          for (int q = 0; q < 2; ++q) { const int idx = tid2 + 512 * q, tap = idx >> 8, col = idx & 255, gcol = (col >> 7) * FF + 128 * u.pn + (col & 127);
              wl[idx] = tap < 3 ? cw[tap * 2 * FF + gcol] : cb[gcol]; } }
        asm volatile("s_waitcnt lgkmcnt(0)" ::: "memory"); __builtin_amdgcn_s_barrier(); asm volatile("" ::: "memory");
        const int gc = 128 * u.pn + c0;
        const int srcp = (fr == 0) ? ((lane + 15) & 63) : ((lane + 63) & 63);
        const int srcn = (fr == 15) ? ((lane + 49) & 63) : ((lane + 1) & 63);
#pragma unroll
        for (int ai = 0; ai < 2; ++ai) {
            const int k = 2 * ai + wr;
#pragma unroll
            for (int n = 0; n < 2; ++n) {
                f32x4 gl[4];
#pragma unroll
                for (int bj = 0; bj < 2; ++bj) {
                    const LAS float* wp = wl + bj * 128 + c0 + 4 * n;
                    const f32x4 w0 = *(const LAS f32x4*)(wp), w1 = *(const LAS f32x4*)(wp + 256), w2 = *(const LAS f32x4*)(wp + 512), bb = *(const LAS f32x4*)(wp + 768);
                    f32x4 eprev = (f32x4){0.f, 0.f, 0.f, 0.f}, enext = eprev;
                    if (k >= 1) eprev = *(const LAS f32x4*)(edge + ((k - 1) * 2 + 1) * 256 + bj * 128 + c0 + 4 * n);
                    if (k <= 2) enext = *(const LAS f32x4*)(edge + ((k + 1) * 2 + 0) * 256 + bj * 128 + c0 + 4 * n);
#pragma unroll
                    for (int m = 0; m < 4; ++m) {
                        const f32x4 v = acc[ai][bj][m][n];
                        f32x4 pv, nv;
#pragma unroll
                        for (int j = 0; j < 4; ++j) {
                            const float supp = (fr == 15 && m > 0) ? acc[ai][bj][m > 0 ? m - 1 : 0][n][j] : v[j];
                            const float supn = (fr == 0 && m < 3) ? acc[ai][bj][m < 3 ? m + 1 : 3][n][j] : v[j];
                            float p = __int_as_float(__builtin_amdgcn_ds_bpermute(srcp * 4, __float_as_int(supp))), q = __int_as_float(__builtin_amdgcn_ds_bpermute(srcn * 4, __float_as_int(supn)));
                            if (m == 0 && fr == 0) p = eprev[j];
                            if (m == 3 && fr == 15) q = enext[j];
                            pv[j] = p; nv[j] = q;
                        }
                        const f32x4 c = w0 * pv + w1 * v + w2 * nv + bb;
                        if (bj == 0) {
#pragma unroll
                            for (int j = 0; j < 4; ++j) gl[m][j] = gelu_tanh(c[j]);
                        } else {
                            const int r = 128 * ai + 64 * wr + 16 * m + fr, s = t * 254 + r - 1;
                            const f32x4 o = gl[m] * c;
                            if (r >= 1 && r <= 254 && s < SEQ) { u32x2 w; w.x = pk2(o[0], o[1]); w.y = pk2(o[2], o[3]);
                                *(u32x2*)(act + (size_t)(b * SEQ + s) * FF + gc + 4 * n) = w; }
                        }
                        __builtin_amdgcn_sched_barrier(0);
                    }
                }
            }
        }
    }
};
}

constexpr int VPITCH = 144;
DI int crow(int reg, int h) { return (reg & 3) + 8 * (reg >> 2) + 4 * h; }
DI bf16x8 pack_step(const f32x16& x, int s) {
    u32x4 p; p.x = pk2(x[8 * s], x[8 * s + 1]); p.y = pk2(x[8 * s + 2], x[8 * s + 3]); p.z = pk2(x[8 * s + 4], x[8 * s + 5]); p.w = pk2(x[8 * s + 6], x[8 * s + 7]);
    return __builtin_bit_cast(bf16x8, p);
}
template <int HW, bool SINK>
DI void attn_task(const bf16_t* qb, const bf16_t* kb_, const bf16_t* vb, int dil, int res, int L, int i0, float sink2,
                  bf16_t* ob, int opitch, float* lseb, LAS unsigned char* vl, int lane) {
    constexpr int NT = (32 + 2 * HW) / 32;
    const int ql = lane & 31, h = lane >> 5;
    const int iq = i0 + ql;
    bf16x8 qf[4];
    { const bf16_t* qp = qb + (size_t)(iq * dil + res) * PROJ_LD + 8 * h;
#pragma unroll
      for (int t = 0; t < 4; ++t) qf[t] = *(const bf16x8*)(qp + 16 * t); }
    f32x16 o0, o1;
#pragma unroll
    for (int i = 0; i < 16; ++i) { o0[i] = 0.f; o1[i] = 0.f; }
    float mrun = SINK ? sink2 : -1e30f, lsum = 0.f;
    const unsigned vaddr = (unsigned)(size_t)vl + (unsigned)((4 * h + ((lane & 15) >> 2)) * VPITCH + (16 * ((lane >> 4) & 1) + 4 * (lane & 3)) * 2);
    for (int jt = 0; jt < NT; ++jt) {
        const int kbase = i0 - HW + 32 * jt;
        int jk = kbase + ql; jk = jk < 0 ? 0 : (jk > L - 1 ? L - 1 : jk);
        const bf16_t* kp = kb_ + (size_t)(jk * dil + res) * PROJ_LD + 8 * h;
        bf16x8 kf[4];
#pragma unroll
        for (int t = 0; t < 4; ++t) kf[t] = *(const bf16x8*)(kp + 16 * t);
        u32x4 vreg[4];
#pragma unroll
        for (int c = 0; c < 4; ++c) { int jv = kbase + 8 * c + (lane >> 3); jv = jv < 0 ? 0 : (jv > L - 1 ? L - 1 : jv);
            vreg[c] = *(const u32x4*)(vb + (size_t)(jv * dil + res) * PROJ_LD + 8 * (lane & 7)); }
        f32x16 sc;
#pragma unroll
        for (int i = 0; i < 16; ++i) sc[i] = 0.f;
#pragma unroll
        for (int t = 0; t < 4; ++t) sc = __builtin_amdgcn_mfma_f32_32x32x16_bf16(kf[t], qf[t], sc, 0, 0, 0);
        asm volatile("" ::: "memory");
#pragma unroll
        for (int c = 0; c < 4; ++c) *(LAS u32x4*)(vl + (8 * c + (lane >> 3)) * VPITCH + 16 * (lane & 7)) = vreg[c];
        asm volatile("" ::: "memory");
        float mt = -INFINITY;
#pragma unroll
        for (int i = 0; i < 16; ++i) { const int j = kbase + crow(i, h); const int dd = j - iq;
            const bool ok = (j >= 0) && (j < L) && (dd <= HW) && (dd >= -HW);
            sc[i] = ok ? sc[i] * LOG2E : -INFINITY; mt = fmaxf(mt, sc[i]); }
        mt = fmaxf(mt, __shfl_xor(mt, 32));
        const float mnew = fmaxf(mrun, mt), alpha = __builtin_amdgcn_exp2f(mrun - mnew);
        mrun = mnew;
        float ps = 0.f;
#pragma unroll
        for (int i = 0; i < 16; ++i) { sc[i] = __builtin_amdgcn_exp2f(sc[i] - mnew); ps += sc[i]; }
        lsum = lsum * alpha + ps;
#pragma unroll
        for (int i = 0; i < 16; ++i) { o0[i] *= alpha; o1[i] *= alpha; }
#pragma unroll
        for (int s = 0; s < 2; ++s) {
            const bf16x8 pf = pack_step(sc, s);
            const unsigned a = vaddr + (unsigned)(16 * s * VPITCH);
            const s16x4 lo0 = __builtin_amdgcn_ds_read_tr16_b64_v4i16((LAS s16x4*)(uintptr_t)(a));
            const s16x4 hi0 = __builtin_amdgcn_ds_read_tr16_b64_v4i16((LAS s16x4*)(uintptr_t)(a + 8 * VPITCH));
            const s16x4 lo1 = __builtin_amdgcn_ds_read_tr16_b64_v4i16((LAS s16x4*)(uintptr_t)(a + 64));
            const s16x4 hi1 = __builtin_amdgcn_ds_read_tr16_b64_v4i16((LAS s16x4*)(uintptr_t)(a + 8 * VPITCH + 64));
            const bf16x8 v0 = __builtin_shufflevector(lo0, hi0, 0, 1, 2, 3, 4, 5, 6, 7), v1 = __builtin_shufflevector(lo1, hi1, 0, 1, 2, 3, 4, 5, 6, 7);
            o0 = __builtin_amdgcn_mfma_f32_32x32x16_bf16(v0, pf, o0, 0, 0, 0);
            o1 = __builtin_amdgcn_mfma_f32_32x32x16_bf16(v1, pf, o1, 0, 0, 0);
        }
        asm volatile("" ::: "memory");
    }
    float l = lsum + __shfl_xor(lsum, 32);
    if (SINK) l += __builtin_amdgcn_exp2f(sink2 - mrun);
    const float inv = 1.0f / l;
    bf16_t* op = ob + (size_t)(iq * dil + res) * opitch + 4 * h;
#pragma unroll
    for (int g = 0; g < 4; ++g) {
        u32x2 w0, w1; w0.x = pk2(o0[4 * g] * inv, o0[4 * g + 1] * inv); w0.y = pk2(o0[4 * g + 2] * inv, o0[4 * g + 3] * inv);
        w1.x = pk2(o1[4 * g] * inv, o1[4 * g + 1] * inv); w1.y = pk2(o1[4 * g + 2] * inv, o1[4 * g + 3] * inv);
        *(u32x2*)(op + 8 * g) = w0; *(u32x2*)(op + 32 + 8 * g) = w1;
    }
    if (lseb != nullptr && h == 0) lseb[(size_t)(iq * dil + res) * 4] = (mrun + __builtin_amdgcn_logf(l)) * 0.6931471805599453f;
}

DI float wave_sum(float v) {
#pragma unroll
    for (int o = 1; o < 64; o <<= 1) v += __shfl_xor(v, o);
    return v;
}
DI int srccol(int mode, int n) {
    if (mode == 1) { const int c128 = n >> 7; if (c128 == 5 || c128 >= 18) return n; const int q = n & 63; return (n & ~63) + 4 * (q >> 3) + (q & 3) + 32 * ((q >> 2) & 1); }
    if (mode == 2) { const int pn = n >> 8, r = n & 255; return r < 128 ? 128 * pn + r : FF + 128 * pn + (r - 128); }
    return n;
}
DI void transpose_item(const float* W, int K, int N, bf16_t* WT, int row_off, int nblk, int mode, LAS float* scr, int item, int lane) {
    const int kb = item / nblk, nb = item % nblk, k0 = 64 * kb, n0 = 32 * nb;
    const int sc = srccol(mode, n0 + (lane & 31));
#pragma unroll 8
    for (int i = 0; i < 32; ++i) { const int kk = 2 * i + (lane >> 5); scr[kk * 33 + (lane & 31)] = W[(size_t)(k0 + kk) * N + sc]; }
    asm volatile("s_waitcnt lgkmcnt(0)" ::: "memory");
    const int c = lane & 7;
#pragma unroll
    for (int j = 0; j < 4; ++j) { const int n = (lane >> 3) + 8 * j; const LAS float* s = scr + (8 * c) * 33 + n;
        u32x4 o; o.x = pk2(s[0 * 33], s[1 * 33]); o.y = pk2(s[2 * 33], s[3 * 33]); o.z = pk2(s[4 * 33], s[5 * 33]); o.w = pk2(s[6 * 33], s[7 * 33]);
        *(u32x4*)(WT + (size_t)(row_off + n0 + n) * K + k0 + 8 * c) = o; }
    asm volatile("s_waitcnt lgkmcnt(0)" ::: "memory");
}
DI unsigned long long pk4(f32x4 o) { return (unsigned long long)pk2(o[0], o[1]) | ((unsigned long long)pk2(o[2], o[3]) << 32); }
DI float dot4(f32x4 v) { return (v[0] * v[0] + v[1] * v[1]) + (v[2] * v[2] + v[3] * v[3]); }

DI void grid_bar(unsigned* cnt, unsigned& epoch, int G) {
    __syncthreads();
    epoch += 1;
    if (threadIdx.x == 0) {
        __builtin_amdgcn_fence(__ATOMIC_RELEASE, "agent");
        __hip_atomic_fetch_add(cnt, 1u, __ATOMIC_RELAXED, __HIP_MEMORY_SCOPE_AGENT);
        const unsigned target = epoch * (unsigned)G;
        while (__hip_atomic_load(cnt, __ATOMIC_RELAXED, __HIP_MEMORY_SCOPE_AGENT) < target) __builtin_amdgcn_s_sleep(4);
        __builtin_amdgcn_fence(__ATOMIC_ACQUIRE, "agent");
    }
    __syncthreads();
}

struct Args { const float* in[16]; float* out; unsigned char* ws; int ph_lo, ph_hi; };
constexpr int NPHASE = 10;

__global__ void __launch_bounds__(512, 2) fwd_megakernel(Args args) {
    extern __shared__ __attribute__((aligned(16))) unsigned char lds_raw[];
    LAS unsigned char* lds = (LAS unsigned char*)lds_raw;
    cg::grid_group grid = cg::this_grid();
    const int G = gridDim.x, bx = blockIdx.x, NGW = G * 8;
#define FRESH_IDS int tid = threadIdx.x; asm volatile("" : "+v"(tid)); const int lane = tid & 63, wave = __builtin_amdgcn_readfirstlane(tid >> 6), gw = bx * 8 + wave; (void)lane; (void)gw
    unsigned* gbar_cnt = (unsigned*)(args.ws + WS_BAR); unsigned gbar_epoch = 0;
    unsigned char* ws = args.ws;
    const float* x = args.in[0];
    float* rowsq1 = (float*)(ws + WS_ROWSQ1); float* rowsq2 = (float*)(ws + WS_ROWSQ2);
    float* rcos = (float*)(ws + WS_ROPE); float* rsin = rcos + SEQ * 32;
    bf16_t* W1T = (bf16_t*)(ws + WS_W1T); bf16_t* WAT = (bf16_t*)(ws + WS_WAT); bf16_t* WBT = (bf16_t*)(ws + WS_WBT);
    bf16_t* WOT = (bf16_t*)(ws + WS_WOT); bf16_t* WUPT = (bf16_t*)(ws + WS_WUPT); bf16_t* WDT = (bf16_t*)(ws + WS_WDT);
    bf16_t* Hb = (bf16_t*)(ws + WS_H); bf16_t* MERGED = Hb;
    bf16_t* PROJ = (bf16_t*)(ws + WS_PROJ); bf16_t* YB = (bf16_t*)(ws + WS_YB); float* TMP = (float*)(ws + WS_TMP);
    bf16_t* H2P = (bf16_t*)(ws + WS_H2P); float* Fb = (float*)(ws + WS_F);
    bf16_t* GATES = (bf16_t*)(ws + WS_GATES); float* Ob = (float*)(ws + WS_O); bf16_t* ACT = (bf16_t*)(ws + WS_ACT);
    bf16_t* YA = (bf16_t*)(ws + WS_YA); bf16_t* OBG = (bf16_t*)(ws + WS_OBG); float* LSE = (float*)(ws + WS_LSE);
    const int lo = args.ph_lo, hi = args.ph_hi;
#ifndef PHMASK
#define PHMASK 0x3ff
#endif
#define IN(k) (((PHMASK >> (k)) & 1) && lo <= (k) && (k) < hi)
#define SEAM(k) do { if (IN(k) && IN((k) + 1)) { if ((k) == 0) grid.sync(); else grid_bar(gbar_cnt, gbar_epoch, G); } } while (0)

    if (IN(0)) {
        FRESH_IDS;
        for (int i = bx * 512 + tid; i < 2 * M; i += G * 512) rowsq1[i] = 0.f;
        for (int i = bx * 512 + tid; i < SEQ * 32; i += G * 512) {
            const int s = i >> 5, f = i & 31;
            const float inv = exp2f(-(float)f * 0.4152410118609203f);
            const float ang = (float)s * inv;
            float sn, cs; sincosf(ang, &sn, &cs);
            rcos[i] = cs; rsin[i] = sn;
        }
        LAS float* scr = (LAS float*)(lds + wave * 16384);
        constexpr int I1 = 16 * 96, I2 = 16 * 64, I3 = 8 * 32, I4 = 4 * 32, I5 = 16 * 32, I6 = 16 * 192, I7 = 48 * 32;
        constexpr int NITEMS = I1 + I2 + I3 + I4 + I5 + I6 + I7;
        for (int it = gw; it < NITEMS; it += NGW) {
            int r = it;
            if (r < I1) { transpose_item(args.in[2], 1024, 3072, W1T, 0, 96, 1, scr, r, lane); continue; } r -= I1;
            if (r < I2) { transpose_item(args.in[6], 1024, 2048, W1T, 3072, 64, 0, scr, r, lane); continue; } r -= I2;
            if (r < I3) { transpose_item(args.in[4], 512, 1024, WAT, 0, 32, 0, scr, r, lane); continue; } r -= I3;
            if (r < I4) { transpose_item(args.in[5], 256, 1024, WBT, 0, 32, 0, scr, r, lane); continue; } r -= I4;
            if (r < I5) { transpose_item(args.in[8], 1024, 1024, WOT, 0, 32, 0, scr, r, lane); continue; } r -= I5;
            if (r < I6) { transpose_item(args.in[11], 1024, 6144, WUPT, 0, 192, 2, scr, r, lane); continue; } r -= I6;
            transpose_item(args.in[14], 3072, 1024, WDT, 0, 32, 0, scr, r, lane);
        }
        const float* gpre = args.in[1];
        for (int m = gw; m < M; m += NGW) {
            const f32x4* xr = (const f32x4*)(x + (size_t)m * D) + lane; const f32x4* gr = (const f32x4*)gpre + lane;
            f32x4 v[4]; float s = 0.f;
#pragma unroll
            for (int j = 0; j < 4; ++j) { v[j] = xr[64 * j]; s += dot4(v[j]); }
            const float r = 1.0f / sqrtf(wave_sum(s) * (1.f / D) + RMS_EPS);
            unsigned long long* o8 = (unsigned long long*)(Hb + (size_t)m * D) + lane;
#pragma unroll
            for (int j = 0; j < 4; ++j) o8[64 * j] = pk4(v[j] * r * gr[64 * j]);
        }
    }
    SEAM(0);

    if (IN(1)) {
        pg8::Gemm g{Hb, W1T, D}; pg8::StaticOrder S; S.init(M / 256, N1 / 256, G, bx, 0);
        pg8::EpiProj E{PROJ, GATES, args.in[7], rcos, rsin};
        pg8::gemm_phase(lds, g, S, E);
    }
    SEAM(1);

    if (IN(2)) {
        FRESH_IDS;
        LAS unsigned char* vl = lds + wave * 16384;
        const float* sink = args.in[3];
        for (int tk = gw; tk < 8192 + 12288; tk += NGW) {
            if (tk < 8192) {
                const int chunk = tk & 127, qh = (tk >> 7) & 7, b = tk >> 10, kvh = qh >> 2;
                const bf16_t* base = PROJ + (size_t)b * SEQ * PROJ_LD;
                attn_task<128, true>(base + qh * 64, base + 512 + kvh * 64, base + 640 + kvh * 64, 1, 0, SEQ, chunk * 32, sink[qh] * LOG2E,
                                     YA + (size_t)b * SEQ * 512 + qh * 64, 512, nullptr, vl, lane);
            } else {
                const int tb = tk - 8192;
                const int chunk = tb & 127, hh = (tb >> 7) & 3, gi = (tb >> 9) % 3, b = tb / 1536;
                const int dil = gi == 0 ? 1 : (gi == 1 ? 4 : 16), L = SEQ / dil, cpr = L / 32;
                const int res = chunk / cpr, i0 = (chunk % cpr) * 32;
                const bf16_t* base = PROJ + (size_t)b * SEQ * PROJ_LD + (gi * 4 + hh) * 64;
                attn_task<64, false>(base + 768, base + 1536, base + 2304, dil, res, L, i0, 0.f,
                                     OBG + ((size_t)gi * M + (size_t)b * SEQ) * 256 + hh * 64, 256, LSE + ((size_t)gi * M + (size_t)b * SEQ) * 4 + hh, vl, lane);
            }
        }
    }
    SEAM(2);

    if (IN(3)) {
        FRESH_IDS;
        for (int i = bx * 512 + tid; i < M * 32; i += G * 512) {
            const int tok = i >> 5, part = i & 31, hh = part >> 3;
            const float l0 = LSE[(size_t)tok * 4 + hh], l1 = LSE[((size_t)M + tok) * 4 + hh], l2 = LSE[((size_t)2 * M + tok) * 4 + hh];
            const float mx = fmaxf(l0, fmaxf(l1, l2));
            float w0 = __expf(l0 - mx), w1 = __expf(l1 - mx), w2 = __expf(l2 - mx);
            const float inv = 1.0f / (w0 + w1 + w2); w0 *= inv; w1 *= inv; w2 *= inv;
            f32x4 a0, a1, b0, b1, c0, c1;
            pg8::unpack8(*(const u32x4*)(OBG + (size_t)tok * 256 + part * 8), a0, a1);
            pg8::unpack8(*(const u32x4*)(OBG + ((size_t)M + tok) * 256 + part * 8), b0, b1);
            pg8::unpack8(*(const u32x4*)(OBG + ((size_t)2 * M + tok) * 256 + part * 8), c0, c1);
            *(u32x4*)(YB + (size_t)tok * 256 + part * 8) = pg8::pack8(a0 * w0 + b0 * w1 + c0 * w2, a1 * w0 + b1 * w1 + c1 * w2);
        }
        pg8::Gemm g{YA, WAT, 512}; pg8::StaticOrder S; S.init(M / 256, D / 256, G, bx, 0);
        pg8::EpiGate<0> E{GATES, TMP, MERGED};
        pg8::gemm_phase(lds, g, S, E);
    }
    SEAM(3);

    if (IN(4)) {
        pg8::Gemm g{YB, WBT, 256}; pg8::StaticOrder S; S.init(M / 256, D / 256, G, bx, 0);
        pg8::EpiGate<1> E{GATES, TMP, MERGED};
        pg8::gemm_phase(lds, g, S, E);
    }
    SEAM(4);

    if (IN(5)) {
        pg8::Gemm g{MERGED, WOT, D}; pg8::StaticOrder S; S.init(M / 256, D / 256, G, bx, 0);
        pg8::EpiOutSq E{Ob, rowsq1};
        pg8::gemm_phase(lds, g, S, E);
    }
    SEAM(5);

    if (IN(6)) {
        FRESH_IDS;
        const float* gpost = args.in[9]; const float* gpre2 = args.in[10];
        for (int m = gw; m < M; m += NGW) {
            const f32x4* orow = (const f32x4*)(Ob + (size_t)m * D) + lane; const f32x4* xr = (const f32x4*)(x + (size_t)m * D) + lane;
            f32x4* x1r = (f32x4*)(args.out + (size_t)m * D) + lane;
            const float r1 = 1.0f / sqrtf(rowsq1[m] * (1.f / D) + RMS_EPS);
            f32x4 v[4]; float s = 0.f;
#pragma unroll
            for (int j = 0; j < 4; ++j) { v[j] = xr[64 * j] + orow[64 * j] * r1 * ((const f32x4*)gpost)[lane + 64 * j]; x1r[64 * j] = v[j]; s += dot4(v[j]); }
            const float r2 = 1.0f / sqrtf(wave_sum(s) * (1.f / D) + RMS_EPS);
            const int b = m >> 12, sq = m & (SEQ - 1);
            unsigned long long* o8 = (unsigned long long*)(H2P + ((size_t)b * H2_ROWS + sq + 1) * D) + lane;
#pragma unroll
            for (int j = 0; j < 4; ++j) o8[64 * j] = pk4(v[j] * r2 * ((const f32x4*)gpre2)[lane + 64 * j]);
        }
        for (int z = gw; z < NB * 224; z += NGW) {
            const int b = z / 224, q = z % 224, p = q == 0 ? 0 : 4096 + q;
            unsigned long long* o8 = (unsigned long long*)(H2P + ((size_t)b * H2_ROWS + p) * D) + lane;
#pragma unroll
            for (int j = 0; j < 4; ++j) o8[64 * j] = 0ull;
        }
    }
    SEAM(6);

    if (IN(7)) {
        pg8::Gemm g{H2P, WUPT, D}; pg8::StaticOrder S; S.init(NB * CONV_TILES, 2 * FF / 256, G, bx, 1);
        pg8::EpiConv E{ACT, args.in[12], args.in[13], (LAS float*)(lds + EDGE_OFF)};
        pg8::gemm_phase(lds, g, S, E);
    }
    SEAM(7);

    if (IN(8)) {
        pg8::Gemm g{ACT, WDT, FF}; pg8::StaticOrder S; S.init(M / 256, D / 256, G, bx, 0);
        pg8::EpiOutSq E{Fb, rowsq2};
        pg8::gemm_phase(lds, g, S, E);
    }
    SEAM(8);

    if (IN(9)) {
        FRESH_IDS;
        const float* gp = args.in[15];
        for (int m = gw; m < M; m += NGW) {
            const f32x4* fr_ = (const f32x4*)(Fb + (size_t)m * D) + lane; f32x4* x1r = (f32x4*)(args.out + (size_t)m * D) + lane;
            const float r = 1.0f / sqrtf(rowsq2[m] * (1.f / D) + RMS_EPS);
#pragma unroll
            for (int j = 0; j < 4; ++j) x1r[64 * j] = x1r[64 * j] + fr_[64 * j] * r * ((const f32x4*)gp)[lane + 64 * j];
        }
    }
#undef IN
#undef SEAM
}

#ifndef MK_PER_PHASE
#define MK_PER_PHASE 0
#endif
extern "C" void kernel_launch(void* const* d_in, const int* in_sizes, int n_in, void* d_out, int out_size, void* d_ws, size_t ws_size, hipStream_t stream) {
    static int grid = 0;
    if (grid == 0) {
        if (n_in != 16 || out_size != M * D || ws_size < WS_END_REQ) { fprintf(stderr, "kernel_launch: unexpected shapes (n_in %d out %d ws %zu)\n", n_in, out_size, ws_size); grid = -1; return; }
        int dev = 0, cus = 0, per_cu = 0;
        (void)hipGetDevice(&dev); (void)hipDeviceGetAttribute(&cus, hipDeviceAttributeMultiprocessorCount, dev);
        if (hipFuncSetAttribute((const void*)fwd_megakernel, hipFuncAttributeMaxDynamicSharedMemorySize, LDS_BYTES) != hipSuccess) { fprintf(stderr, "kernel_launch: hipFuncSetAttribute failed\n"); grid = -1; return; }
        if (hipOccupancyMaxActiveBlocksPerMultiprocessor(&per_cu, (const void*)fwd_megakernel, 512, LDS_BYTES) != hipSuccess || per_cu < 1) { fprintf(stderr, "kernel_launch: occupancy query says %d\n", per_cu); per_cu = 1; }
        (void)hipGetLastError();
        grid = cus;
    }
    if (grid < 0) return;
    (void)hipMemsetAsync((unsigned char*)d_ws + WS_BAR, 0, 256, stream);
    Args a{};
    for (int i = 0; i < 16; ++i) a.in[i] = (const float*)d_in[i];
    a.out = (float*)d_out; a.ws = (unsigned char*)d_ws;
#if MK_PER_PHASE
    for (int p = 0; p < NPHASE; ++p) { a.ph_lo = p; a.ph_hi = p + 1; hipLaunchKernelGGL(fwd_megakernel, dim3(grid), dim3(512), LDS_BYTES, stream, a); }
#else
    a.ph_lo = 0; a.ph_hi = NPHASE;
    void* kargs[] = {&a};
    hipError_t e = hipLaunchCooperativeKernel((const void*)fwd_megakernel, dim3(grid), dim3(512), kargs, LDS_BYTES, stream);
    if (e != hipSuccess) fprintf(stderr, "cooperative launch failed: %s (grid %d)\n", hipGetErrorString(e), grid);
#endif
}
```
